# Optimizing an MI355X kernel written in HIP

```python
import math
import jax
import jax.numpy as jnp
from jax import lax
import numpy as np

D_MODEL = 2048
BATCH = 8
SEQ = 2048
DEPTH = 1
DEC_BATCH = 16
DEC_SEQ = 32
PAST_LEN = 2048

CHUNK = 64
WINDOW = 128
WINDOW_CHUNKS = WINDOW // CHUNK
HEAD_DIM = 64
D_MIX = D_MODEL
D_ATTN = D_MIX // 2
D_LRU = D_MIX - D_ATTN
N_Q_HEADS = D_ATTN // HEAD_DIM
N_KV_HEADS = 4
GQA_GROUP = N_Q_HEADS // N_KV_HEADS
D_KV = N_KV_HEADS * HEAD_DIM
N_LRU_BLOCKS = 16
LRU_BLOCK = D_LRU // N_LRU_BLOCKS
CONV_WIDTH = 4
LRU_C = 8.0
D_IN = 2 * D_ATTN + 2 * D_KV + 2 * D_LRU
SPLIT_POINTS = (D_ATTN, D_ATTN + D_KV, D_ATTN + 2 * D_KV, 2 * D_ATTN + 2 * D_KV,
                2 * D_ATTN + 2 * D_KV + D_LRU)
DEEPNORM_ALPHA = (2.0 * DEPTH) ** 0.25
DEEPNORM_BETA = (8.0 * DEPTH) ** -0.25
LN_EPS = 1e-5
NEG_INF = -1e30

kernel_name = "hymba_swa_sink_alibi_rglru_deepnorm_step"


def _alibi_slopes():
    h = jnp.arange(1, N_Q_HEADS + 1, dtype=jnp.float32)
    return jnp.exp2(-8.0 * h / N_Q_HEADS).reshape(N_KV_HEADS, GQA_GROUP)


def _band_attention(q, k, v, qpos, kpos, sinks):
    qc = qpos // CHUNK
    kc = kpos // CHUNK
    valid = ((kpos[:, None, :] >= 0)
             & (kc[:, None, :] <= qc[:, :, None])
             & (kc[:, None, :] >= qc[:, :, None] - WINDOW_CHUNKS))
    dist = jnp.abs(qpos[:, :, None] - kpos[:, None, :]).astype(jnp.float32)
    slopes = _alibi_slopes()
    s = jnp.einsum('bnqhgd,bnkhd->bnhgqk', q.astype(jnp.float32), k.astype(jnp.float32))
    s = s * (HEAD_DIM ** -0.5) - slopes[None, None, :, :, None, None] * dist[None, :, None, None]
    s = jnp.where(valid[None, :, None, None], s, NEG_INF)
    sink = sinks.astype(jnp.float32).reshape(N_KV_HEADS, GQA_GROUP)[None, None, :, :, None, None]
    m = jnp.maximum(jnp.max(s, axis=-1, keepdims=True), sink)
    e = jnp.exp(s - m)
    p = e / (jnp.sum(e, axis=-1, keepdims=True) + jnp.exp(sink - m))
    return jnp.einsum('bnhgqk,bnkhd->bnqhgd', p, v.astype(jnp.float32))


def _attn_prompt(q, k, v, sinks):
    B, S = q.shape[0], q.shape[1]
    nC = S // CHUNK
    pad = WINDOW_CHUNKS * CHUNK
    qb = q.reshape(B, nC, CHUNK, N_KV_HEADS, GQA_GROUP, HEAD_DIM)

    def band(t):
        tp = jnp.pad(t, ((0, 0), (pad, 0), (0, 0), (0, 0))).reshape(B, nC + WINDOW_CHUNKS, CHUNK, N_KV_HEADS, HEAD_DIM)
        return jnp.concatenate([tp[:, j:j + nC] for j in range(WINDOW_CHUNKS + 1)], axis=2)

    kb, vb = band(k), band(v)
    qpos = jnp.arange(S, dtype=jnp.int32).reshape(nC, CHUNK)
    kpos = (jnp.arange(nC, dtype=jnp.int32)[:, None] * CHUNK - pad
            + jnp.arange((WINDOW_CHUNKS + 1) * CHUNK, dtype=jnp.int32)[None, :])
    o = _band_attention(qb, kb, vb, qpos, kpos, sinks)
    return o.reshape(B, S, D_ATTN)


def _attn_sample(q, k_all, v_all, sinks):
    B, T = q.shape[0], q.shape[1]
    n_keys = k_all.shape[1]
    qpos = (PAST_LEN + jnp.arange(T, dtype=jnp.int32))[None]
    kpos = (PAST_LEN + T - n_keys + jnp.arange(n_keys, dtype=jnp.int32))[None]
    o = _band_attention(q[:, None], k_all[:, None], v_all[:, None], qpos, kpos, sinks)
    return o.reshape(B, T, D_ATTN)


def _block_diag(x, w, b):
    B, T = x.shape[0], x.shape[1]
    xb = x.reshape(B, T, N_LRU_BLOCKS, LRU_BLOCK)
    return (jnp.einsum('btnd,nde->btne', xb, w) + b).reshape(B, T, D_LRU)


def _rglru(x, h0, w_ga, b_ga, w_gx, b_gx, lam):
    xf = x.astype(jnp.float32)
    r = jax.nn.sigmoid(_block_diag(xf, w_ga.astype(jnp.float32), b_ga.astype(jnp.float32)))
    i = jax.nn.sigmoid(_block_diag(xf, w_gx.astype(jnp.float32), b_gx.astype(jnp.float32)))
    log_a = -LRU_C * r * jax.nn.softplus(-lam.astype(jnp.float32))
    a = jnp.exp(log_a)
    mult = jnp.sqrt(jnp.maximum(-jnp.expm1(2.0 * log_a), 0.0))
    bterm = mult * (i * xf)
    bterm = bterm.at[:, 0].add(a[:, 0] * h0.astype(jnp.float32))

    def combine(lhs, rhs):
        a1, b1 = lhs
        a2, b2 = rhs
        return a1 * a2, a2 * b1 + b2

    _, h = lax.associative_scan(combine, (a, bterm), axis=1)
    return h


def _layer_norm(y, g, b):
    yf = y.astype(jnp.float32)
    mu = jnp.mean(yf, axis=-1, keepdims=True)
    var = jnp.mean(jnp.square(yf - mu), axis=-1, keepdims=True)
    return ((yf - mu) * lax.rsqrt(var + LN_EPS) * g.astype(jnp.float32) + b.astype(jnp.float32)).astype(y.dtype)


def _layer(x, k_cache, v_cache, conv_ctx, h0, w_in, b_in, conv_w, conv_b, w_ga, b_ga, w_gx, b_gx,
           lam, sinks, w_out, ln_g, ln_b):
    B, T = x.shape[0], x.shape[1]
    z = jnp.einsum('btd,de->bte', x, w_in) + b_in
    q, k, v, g_attn, x_lru, g_lru = jnp.split(z, SPLIT_POINTS, axis=-1)
    q = q.reshape(B, T, N_KV_HEADS, GQA_GROUP, HEAD_DIM)
    k = k.reshape(B, T, N_KV_HEADS, HEAD_DIM)
    v = v.reshape(B, T, N_KV_HEADS, HEAD_DIM)

    if k_cache is None:
        o_attn = _attn_prompt(q, k, v, sinks)
        k_all, v_all = k, v
    else:
        k_all = jnp.concatenate([k_cache.astype(k.dtype), k], axis=1)
        v_all = jnp.concatenate([v_cache.astype(v.dtype), v], axis=1)
        o_attn = _attn_sample(q, k_all, v_all, sinks)
    k_win = k_all[:, -WINDOW:]
    v_win = v_all[:, -WINDOW:]

    conv_in = jnp.concatenate([conv_ctx.astype(x_lru.dtype), x_lru], axis=1)
    xc = conv_b + sum(conv_in[:, j:j + T] * conv_w[j] for j in range(CONV_WIDTH))
    h = _rglru(xc, h0, w_ga, b_ga, w_gx, b_gx, lam)
    conv_new = conv_in[:, -(CONV_WIDTH - 1):]
    h_new = h[:, -1].astype(x.dtype)

    u = jnp.concatenate([o_attn.astype(x.dtype) * jax.nn.silu(g_attn),
                         h.astype(x.dtype) * jax.nn.silu(g_lru)], axis=-1)
    y = _layer_norm(DEEPNORM_ALPHA * x + jnp.einsum('bte,ed->btd', u, w_out), ln_g, ln_b)
    return y, k_win, v_win, conv_new, h_new


def setup_inputs(seed: int = 0) -> dict:
    key = jax.random.key(seed)
    ks = jax.random.split(key, 20)
    kv_buf = min(WINDOW, PAST_LEN)
    f32 = jnp.float32
    a0 = jax.random.uniform(ks[13], (DEPTH, D_LRU), f32, 0.9, 0.999)
    return {
        "x_prompt": jax.random.normal(ks[0], (BATCH, SEQ, D_MODEL), f32),
        "x_sample": jax.random.normal(ks[1], (DEC_BATCH, DEC_SEQ, D_MODEL), f32),
        "cache_k": jax.random.normal(ks[2], (DEPTH, DEC_BATCH, kv_buf, N_KV_HEADS, HEAD_DIM), f32),
        "cache_v": jax.random.normal(ks[3], (DEPTH, DEC_BATCH, kv_buf, N_KV_HEADS, HEAD_DIM), f32),
        "state_conv": jax.random.normal(ks[4], (DEPTH, DEC_BATCH, CONV_WIDTH - 1, D_LRU), f32),
        "state_h": jax.random.normal(ks[5], (DEPTH, DEC_BATCH, D_LRU), f32),
        "w_in": jax.random.normal(ks[6], (DEPTH, D_MODEL, D_IN), f32) * D_MODEL ** -0.5,
        "b_in": jax.random.normal(ks[7], (DEPTH, D_IN), f32) * 0.02,
        "conv_w": jax.random.normal(ks[8], (DEPTH, CONV_WIDTH, D_LRU), f32) * CONV_WIDTH ** -0.5,
        "conv_b": jax.random.normal(ks[9], (DEPTH, D_LRU), f32) * 0.02,
        "w_gate_a": jax.random.normal(ks[10], (DEPTH, N_LRU_BLOCKS, LRU_BLOCK, LRU_BLOCK), f32) * LRU_BLOCK ** -0.5,
        "b_gate_a": jax.random.normal(ks[11], (DEPTH, N_LRU_BLOCKS, LRU_BLOCK), f32) * 0.02,
        "w_gate_x": jax.random.normal(ks[12], (DEPTH, N_LRU_BLOCKS, LRU_BLOCK, LRU_BLOCK), f32) * LRU_BLOCK ** -0.5,
        "b_gate_x": jax.random.normal(ks[14], (DEPTH, N_LRU_BLOCKS, LRU_BLOCK), f32) * 0.02,
        "lru_lambda": jnp.log(a0) - jnp.log1p(-a0),
        "attn_sinks": jax.random.normal(ks[15], (DEPTH, N_Q_HEADS), f32),
        "w_out": jax.random.normal(ks[16], (DEPTH, D_MIX, D_MODEL), f32) * (D_MIX ** -0.5) * DEEPNORM_BETA,
        "ln_g": 1.0 + 0.02 * jax.random.normal(ks[17], (DEPTH, D_MODEL), f32),
        "ln_b": 0.02 * jax.random.normal(ks[18], (DEPTH, D_MODEL), f32),
    }


def reference(x_prompt, x_sample, cache_k, cache_v, state_conv, state_h, w_in, b_in, conv_w, conv_b,
              w_gate_a, b_gate_a, w_gate_x, b_gate_x, lru_lambda, attn_sinks, w_out, ln_g, ln_b):
    yp, ys = x_prompt, x_sample
    pk, pv, pc, ph = [], [], [], []
    sk, sv, sc, sh = [], [], [], []
    for l in range(DEPTH):
        w = (w_in[l], b_in[l], conv_w[l], conv_b[l], w_gate_a[l], b_gate_a[l], w_gate_x[l], b_gate_x[l],
             lru_lambda[l], attn_sinks[l], w_out[l], ln_g[l], ln_b[l])
        conv0 = jnp.zeros((yp.shape[0], CONV_WIDTH - 1, D_LRU), yp.dtype)
        h0 = jnp.zeros((yp.shape[0], D_LRU), jnp.float32)
        yp, k1, v1, c1, h1 = _layer(yp, None, None, conv0, h0, *w)
        ys, k2, v2, c2, h2 = _layer(ys, cache_k[l], cache_v[l], state_conv[l], state_h[l], *w)
        pk.append(k1); pv.append(v1); pc.append(c1); ph.append(h1)
        sk.append(k2); sv.append(v2); sc.append(c2); sh.append(h2)
    return (yp, ys, jnp.stack(pk), jnp.stack(pv), jnp.stack(pc), jnp.stack(ph),
            jnp.stack(sk), jnp.stack(sv), jnp.stack(sc), jnp.stack(sh))
```

```cpp
#include <hip/hip_runtime.h>
#include <cstdio>
#include <cstdint>
namespace pg8 {
#define PG8_LAS __attribute__((address_space(3)))
typedef unsigned short bf16_t;
typedef short bf16x8 __attribute__((ext_vector_type(8)));
typedef float f32x4 __attribute__((ext_vector_type(4)));
typedef unsigned u32x4 __attribute__((ext_vector_type(4)));
constexpr int BM = 256, BK = 64, HALF = 128, HTB = HALF * BK * 2  , STAGE_BYTES = 8 * HTB, NXCD = 8, WGM = 8;

__host__ __device__ __forceinline__ int lds_byte(int r, int c) { const int st = (r >> 4) * 2 + (c >> 5), rr = r & 15, cc = c & 31, ob = rr * 64 + cc * 2; return st * 1024 + (ob ^ (((ob >> 9) & 1) << 5)); }
__host__ __device__ __forceinline__ void stage_rc(int b, int& R, int& C) { const int st = b / 1024, sb = b % 1024, swz = sb ^ (((sb >> 9) & 1) << 5); R = (st >> 1) * 16 + swz / 64; C = (st & 1) * 32 + (swz % 64) / 2; }
__host__ __device__ __forceinline__ int perm32(int rho) { const int n = rho >> 4, i = rho & 15; return 8 * (i >> 2) + 4 * n + (i & 3); }

struct Unit { int pm, pn; };
struct Gemm { const bf16_t* A; const bf16_t* Bt; int M, N, K; };

struct StaticOrder {
    int nM, nN, nwg, G, c;
    __host__ __device__ void init(int M, int N, int G_, int c_) { nM = M / BM; nN = N / BM; nwg = nM * nN; G = G_; c = c_; }
    __host__ __device__ bool next(int i, Unit& u) const {
        const long L = (long)i * G + c; if (L >= nwg) return false;
        int wgid = (int)L; { const int q = nwg / NXCD, r = nwg % NXCD, xcd = wgid % NXCD, off = wgid / NXCD; wgid = (xcd < r ? xcd * (q + 1) : r * (q + 1) + (xcd - r) * q) + off; }
        const int nig = WGM * nN, gid = wgid / nig, fm = gid * WGM, gsz = (nM - fm) < WGM ? (nM - fm) : WGM;
        u.pm = fm + ((wgid % nig) % gsz); u.pn = (wgid % nig) / gsz; return true;
    }
    __device__ __forceinline__ void a_ready(const Unit&) const {}
    __device__ __forceinline__ void done(const Unit&) const {}
};

__device__ __forceinline__ unsigned cvt_pk_bf16(float lo, float hi) { unsigned r; asm volatile("v_cvt_pk_bf16_f32 %0, %1, %2" : "=v"(r) : "v"(lo), "v"(hi)); return r; }
typedef float f32x2 __attribute__((ext_vector_type(2)));
__device__ __forceinline__ float silu_f(float v) { return v * __builtin_amdgcn_rcpf(1.0f + __expf(-v)); }
struct EpiZ {
    static constexpr bool PERM = true, AFTER_DRAIN = false;
    bf16_t *Q, *KB, *VB, *GA, *XL, *GL; const float* bias; float* out; float qscale;
    __device__ __forceinline__ void operator()(const f32x4 (&acc)[2][2][4][2], const Unit& u, int wr, int wc, int fr, int fq) const {
        constexpr int MP = 16384;
        constexpr size_t OFF_KWP = 34603008, OFF_VWP = OFF_KWP + 262144, OFF_CP = OFF_VWP + 262144, OFF_HP = OFF_CP + 24576,
                         OFF_KWS = OFF_HP + 8192, OFF_VWS = OFF_KWS + 524288, OFF_CS = OFF_VWS + 524288;
        const int pn = u.pn, row0 = u.pm * BM + wr * 64 + fr, colt = wc * 32 + 8 * fq;
        f32x4 bv[2][2];
#pragma unroll
        for (int bj = 0; bj < 2; ++bj)
#pragma unroll
            for (int n = 0; n < 2; ++n) bv[bj][n] = *(const f32x4*)(bias + pn * BM + colt + bj * HALF + 4 * n);
        int kind; bf16_t* base; int ldc, cbase;
        if (pn < 4)       { kind = 0; base = Q;  ldc = 1024; cbase = pn * 256; }
        else if (pn == 4) { kind = 1; base = KB; ldc = 256;  cbase = 0; }
        else if (pn == 5) { kind = 2; base = VB; ldc = 256;  cbase = 0; }
        else if (pn < 10) { kind = 3; base = GA; ldc = 1024; cbase = (pn - 6) * 256; }
        else if (pn < 14) { kind = 4; base = XL; ldc = 1024; cbase = (pn - 10) * 256; }
        else              { kind = 5; base = GL; ldc = 1024; cbase = (pn - 14) * 256; }
        const bool act = (kind == 3) || (kind == 5);
        const float sc = (kind == 0) ? qscale : 1.0f;
#pragma unroll
        for (int ai = 0; ai < 2; ++ai)
#pragma unroll
            for (int m = 0; m < 4; ++m) {
                const int r = row0 + ai * HALF + m * 16;
                int drow = r;
                const bool samp = r >= MP; const int rs = r - MP;
                if ((kind == 1 || kind == 2) && samp) drow = MP + (rs >> 5) * 160 + 128 + (rs & 31);
                bf16_t* rowp = base + (size_t)drow * ldc + cbase + colt;
                float* fo = nullptr;
                if (kind == 1 || kind == 2) {
                    if (!samp) { const int t = r & 2047, b = r >> 11; if (t >= 1920) fo = out + (kind == 1 ? OFF_KWP : OFF_VWP) + (size_t)(b * 128 + t - 1920) * 256 + colt; }
                    else { const int b = rs >> 5, t = rs & 31; fo = out + (kind == 1 ? OFF_KWS : OFF_VWS) + (size_t)(b * 128 + 96 + t) * 256 + colt; }
                } else if (kind == 4) {
                    if (!samp) { const int t = r & 2047, b = r >> 11; if (t >= 2045) fo = out + OFF_CP + (size_t)(b * 3 + t - 2045) * 1024 + cbase + colt; }
                    else { const int b = rs >> 5, t = rs & 31; if (t >= 29) fo = out + OFF_CS + (size_t)(b * 3 + t - 29) * 1024 + cbase + colt; }
                }
#pragma unroll
                for (int bj = 0; bj < 2; ++bj) {
                    f32x4 v0 = acc[ai][bj][m][0] + bv[bj][0], v1 = acc[ai][bj][m][1] + bv[bj][1];
                    if (fo) { *(f32x4*)(fo + bj * HALF) = v0; *(f32x4*)(fo + bj * HALF + 4) = v1; }
                    if (act) {
#pragma unroll
                        for (int j = 0; j < 4; ++j) { v0[j] = silu_f(v0[j]); v1[j] = silu_f(v1[j]); }
                    }
                    v0 = v0 * sc; v1 = v1 * sc;
                    u32x4 w; w.x = cvt_pk_bf16(v0[0], v0[1]); w.y = cvt_pk_bf16(v0[2], v0[3]); w.z = cvt_pk_bf16(v1[0], v1[1]); w.w = cvt_pk_bf16(v1[2], v1[3]);
                    *(u32x4*)(rowp + bj * HALF) = w;
                }
            }
    }
};
struct EpiPre {
    static constexpr bool PERM = false, AFTER_DRAIN = false;
    const float* xp; const float* xs; float* out; float alpha;
    __device__ __forceinline__ void operator()(const f32x4 (&acc)[2][2][4][2], const Unit& u, int wr, int wc, int fr, int fq) const {
        constexpr int MP = 16384, D = 2048;
        const int row0 = u.pm * BM + wr * 64 + fr, col0 = u.pn * BM + wc * 32 + 4 * fq;
#pragma unroll
        for (int ai = 0; ai < 2; ++ai)
#pragma unroll
            for (int m = 0; m < 4; ++m) {
                const int r = row0 + ai * HALF + m * 16;
                const float* xr = (r < MP) ? xp + (size_t)r * D : xs + (size_t)(r - MP) * D;
                float* orow = out + (size_t)r * D + col0;
#pragma unroll
                for (int bj = 0; bj < 2; ++bj)
#pragma unroll
                    for (int n = 0; n < 2; ++n) { const f32x4 xv = *(const f32x4*)(xr + col0 + bj * HALF + n * 16); *(f32x4*)(orow + bj * HALF + n * 16) = xv * alpha + acc[ai][bj][m][n]; }
            }
    }
};

template <class Epi, class Sched, bool ALIGN_EPI = false, bool SP2 = false>
__device__ __forceinline__ void gemm_phase(PG8_LAS unsigned char* lds, const Gemm g, const Sched& S, const Epi& E) {
    const int tid = threadIdx.x, wid = __builtin_amdgcn_readfirstlane(tid >> 6), lane = tid & 63, wr = wid >> 2, wc = wid & 3, fr = lane & 15, fq = lane >> 4;
    const int K = g.K, nt = K / BK;
    unsigned voffA[2], voffB[2];
#pragma unroll
    for (int i = 0; i < 2; ++i) { int R, C; stage_rc(tid * 16 + i * 8192, R, C); const int Rb = Epi::PERM ? ((R & ~31) + perm32(R & 31)) : R;
        voffA[i] = (unsigned)(R * K + C) * 2u; voffB[i] = (unsigned)(Rb * K + C) * 2u; }
    const size_t kstep = (size_t)(BK * 2);
    const size_t hstep = (size_t)HALF * K * 2;
    const size_t tstep = 2 * hstep;
    const unsigned ldsw = (unsigned)wid * 1024u;
    const int aoff = lds_byte(wr * 64 + fr, fq * 8), boff = lds_byte(wc * 32 + fr, fq * 8);
#define PG8_SA(b, h) (((b) * 2 + (h)) * HTB)
#define PG8_SB(b, h) ((4 + (b) * 2 + (h)) * HTB)
#define PG8_STAGE(bufoff, gbase, voff) do { _Pragma("unroll") for (int _i = 0; _i < 2; ++_i) \
        __builtin_amdgcn_global_load_lds((const unsigned*)((const char*)(gbase) + (voff)[_i]), (PG8_LAS unsigned*)(lds + (bufoff) + ldsw + _i * 8192), 16, 0, 0); } while (0)
#define PG8_LDA(dst, b, h) do { _Pragma("unroll") for (int m = 0; m < 4; ++m) _Pragma("unroll") for (int k = 0; k < 2; ++k) dst[m][k] = *(const PG8_LAS bf16x8*)(lds + PG8_SA(b, h) + aoff + m * 2048 + k * 1024); } while (0)
#define PG8_LDB(dst, b, h) do { _Pragma("unroll") for (int n = 0; n < 2; ++n) _Pragma("unroll") for (int k = 0; k < 2; ++k) dst[n][k] = *(const PG8_LAS bf16x8*)(lds + PG8_SB(b, h) + boff + n * 2048 + k * 1024); } while (0)
#define PG8_MMA(ai, bj, At, Bt) do { __builtin_amdgcn_s_setprio(1); _Pragma("unroll") for (int m = 0; m < 4; ++m) _Pragma("unroll") for (int n = 0; n < 2; ++n) _Pragma("unroll") for (int k = 0; k < 2; ++k) \
        acc[ai][bj][m][n] = __builtin_amdgcn_mfma_f32_16x16x32_bf16(Bt[n][k], At[m][k], acc[ai][bj][m][n], 0, 0, 0); __builtin_amdgcn_s_setprio(0); } while (0)
#define PG8_WAIT_V(n) asm volatile("s_waitcnt vmcnt(" #n ")" ::: "memory")
#define PG8_WAIT_L(n) asm volatile("s_waitcnt lgkmcnt(" #n ")" ::: "memory")
#define PG8_BAR __builtin_amdgcn_s_barrier()
#define PG8_SCHED __builtin_amdgcn_sched_barrier(0)
    Unit cur, nxt; int ui = 0;
    if (!S.next(0, cur)) return;
    f32x4 acc[2][2][4][2];
#pragma unroll
    for (int a = 0; a < 2; ++a)
#pragma unroll
        for (int b = 0; b < 2; ++b)
#pragma unroll
            for (int m = 0; m < 4; ++m)
#pragma unroll
                for (int n = 0; n < 2; ++n) acc[a][b][m][n] = (f32x4){0.f, 0.f, 0.f, 0.f};
    bf16x8 At[4][2], B0[2][2], B1[2][2];
    const char* cA = (const char*)g.A + (size_t)cur.pm * tstep; const char* cB = (const char*)g.Bt + (size_t)cur.pn * tstep;
    S.a_ready(cur);
    if constexpr (SP2) {
        PG8_STAGE(PG8_SB(0, 0), cB, voffB); PG8_STAGE(PG8_SB(0, 1), cB + hstep, voffB); PG8_STAGE(PG8_SA(0, 0), cA, voffA); PG8_STAGE(PG8_SA(0, 1), cA + hstep, voffA);
        if (wr == 1) PG8_BAR;
        PG8_WAIT_V(2); PG8_BAR;
        PG8_STAGE(PG8_SB(1, 0), cB + kstep, voffB); PG8_STAGE(PG8_SA(1, 0), cA + kstep, voffA); PG8_STAGE(PG8_SB(1, 1), cB + hstep + kstep, voffB);
        PG8_WAIT_V(6); PG8_BAR;
    } else {
        PG8_STAGE(PG8_SB(0, 0), cB, voffB); PG8_STAGE(PG8_SA(0, 0), cA, voffA); PG8_STAGE(PG8_SB(0, 1), cB + hstep, voffB); PG8_STAGE(PG8_SA(0, 1), cA + hstep, voffA);
        if (wr == 1) PG8_BAR;
        PG8_WAIT_V(4); PG8_BAR;
        PG8_STAGE(PG8_SB(1, 0), cB + kstep, voffB); PG8_STAGE(PG8_SA(1, 0), cA + kstep, voffA); PG8_STAGE(PG8_SB(1, 1), cB + hstep + kstep, voffB);
        PG8_WAIT_V(6); PG8_BAR;
    }
    for (;;) {
        const bool has_next = S.next(ui + 1, nxt);
        const char* nA = has_next ? (const char*)g.A + (size_t)nxt.pm * tstep : cA; const char* nB = has_next ? (const char*)g.Bt + (size_t)nxt.pn * tstep : cB;
        for (int t = 0; t < nt; t += 2) {
            const bool last = (t == nt - 2);
            const char* a1 = cA + (size_t)(t + 1) * kstep;
            const char* a2 = last ? nA : cA + (size_t)(t + 2) * kstep; const char* b2 = last ? nB : cB + (size_t)(t + 2) * kstep;
            const char* a3 = a2 + kstep; const char* b3 = b2 + kstep;
            if (last && has_next) S.a_ready(nxt);
            if constexpr (SP2) {
            PG8_LDB(B0, 0, 0); PG8_LDB(B1, 0, 1); PG8_SCHED; PG8_LDA(At, 0, 0); PG8_STAGE(PG8_SA(1, 1), a1 + hstep, voffA);
            PG8_WAIT_V(8); PG8_WAIT_L(0); PG8_BAR; PG8_MMA(0, 0, At, B0); PG8_MMA(0, 1, At, B1); PG8_BAR; PG8_SCHED;
            PG8_LDA(At, 0, 1); PG8_STAGE(PG8_SB(0, 0), b2, voffB); PG8_STAGE(PG8_SB(0, 1), b2 + hstep, voffB); PG8_STAGE(PG8_SA(0, 0), a2, voffA);
            PG8_WAIT_V(8); PG8_WAIT_L(0); PG8_BAR; PG8_MMA(1, 0, At, B0); PG8_MMA(1, 1, At, B1); PG8_BAR; PG8_SCHED;
            PG8_LDB(B0, 1, 0); PG8_LDB(B1, 1, 1); PG8_SCHED; PG8_LDA(At, 1, 0); PG8_STAGE(PG8_SA(0, 1), a2 + hstep, voffA);
            PG8_WAIT_V(8); PG8_WAIT_L(0); PG8_BAR; PG8_MMA(0, 0, At, B0); PG8_MMA(0, 1, At, B1); PG8_BAR; PG8_SCHED;
            PG8_LDA(At, 1, 1); PG8_STAGE(PG8_SB(1, 0), b3, voffB); PG8_STAGE(PG8_SB(1, 1), b3 + hstep, voffB); PG8_STAGE(PG8_SA(1, 0), a3, voffA);
            PG8_WAIT_V(8); PG8_WAIT_L(0); PG8_BAR; PG8_MMA(1, 0, At, B0); PG8_MMA(1, 1, At, B1); PG8_BAR; PG8_SCHED;
            } else {
            PG8_LDB(B0, 0, 0); PG8_SCHED; PG8_LDA(At, 0, 0); PG8_STAGE(PG8_SA(1, 1), a1 + hstep, voffA);
            PG8_WAIT_L(8); PG8_BAR; PG8_WAIT_L(0); PG8_MMA(0, 0, At, B0); PG8_BAR; PG8_SCHED;
            PG8_LDB(B1, 0, 1); PG8_STAGE(PG8_SB(0, 0), b2, voffB);
            PG8_BAR; PG8_WAIT_L(0); PG8_MMA(0, 1, At, B1); PG8_BAR;
            PG8_LDA(At, 0, 1); PG8_STAGE(PG8_SA(0, 0), a2, voffA);
            PG8_BAR; PG8_WAIT_L(0); PG8_MMA(1, 0, At, B0); PG8_BAR; PG8_SCHED;
            PG8_STAGE(PG8_SB(0, 1), b2 + hstep, voffB);
            PG8_WAIT_V(6); PG8_BAR; PG8_MMA(1, 1, At, B1); PG8_BAR;
            PG8_LDB(B0, 1, 0); PG8_SCHED; PG8_LDA(At, 1, 0); PG8_STAGE(PG8_SA(0, 1), a2 + hstep, voffA);
            PG8_WAIT_L(8); PG8_BAR; PG8_WAIT_L(0); PG8_MMA(0, 0, At, B0); PG8_BAR; PG8_SCHED;
            PG8_LDB(B1, 1, 1); PG8_STAGE(PG8_SB(1, 0), b3, voffB);
            PG8_BAR; PG8_WAIT_L(0); PG8_MMA(0, 1, At, B1); PG8_BAR;
            PG8_LDA(At, 1, 1); PG8_STAGE(PG8_SA(1, 0), a3, voffA);
            PG8_BAR; PG8_WAIT_L(0); PG8_MMA(1, 0, At, B0); PG8_BAR; PG8_SCHED;
            PG8_STAGE(PG8_SB(1, 1), b3 + hstep, voffB);
            PG8_WAIT_V(6); PG8_BAR; PG8_MMA(1, 1, At, B1); PG8_BAR;
            }
        }
        if constexpr (ALIGN_EPI) { if (wr == 0) PG8_BAR; }
        if constexpr (!Epi::AFTER_DRAIN) { E(acc, cur, wr, wc, fr, fq); S.done(cur); }
        if (!has_next) break;
#pragma unroll
        for (int a = 0; a < 2; ++a)
#pragma unroll
            for (int b = 0; b < 2; ++b)
#pragma unroll
                for (int m = 0; m < 4; ++m)
#pragma unroll
                    for (int n = 0; n < 2; ++n) acc[a][b][m][n] = (f32x4){0.f, 0.f, 0.f, 0.f};
        cur = nxt; cA = nA; cB = nB; ++ui;
        if constexpr (ALIGN_EPI) { if (wr == 1) PG8_BAR; }
    }
    PG8_WAIT_V(0);
    if constexpr (!ALIGN_EPI) { if (wr == 0) PG8_BAR; }
    PG8_BAR;
    if constexpr (Epi::AFTER_DRAIN) { E.fused(acc, cur, wr, wc, fr, fq, lds, wid, lane); S.done(cur); }
#undef PG8_SA
#undef PG8_SB
#undef PG8_STAGE
#undef PG8_LDA
#undef PG8_LDB
#undef PG8_MMA
#undef PG8_WAIT_V
#undef PG8_WAIT_L
#undef PG8_BAR
#undef PG8_SCHED
}
}
#define GAS __attribute__((address_space(1)))
#define LAS __attribute__((address_space(3)))
typedef unsigned short bf16;
typedef unsigned v4u __attribute__((ext_vector_type(4)));
typedef float f32x4 __attribute__((ext_vector_type(4)));
typedef short bf16x8 __attribute__((ext_vector_type(8)));
typedef GAS unsigned gu32;
typedef GAS unsigned long long gu64;
#define RLX_AGENT __ATOMIC_RELAXED, __HIP_MEMORY_SCOPE_AGENT
#define LDS_WAIT() asm volatile("s_waitcnt lgkmcnt(0)" ::: "memory")
#define VM_WAIT() asm volatile("s_waitcnt vmcnt(0)" ::: "memory")
__device__ __forceinline__ unsigned long long rt() { return __builtin_amdgcn_s_memrealtime(); }
__device__ __forceinline__ unsigned f2bf(float f) { unsigned u = __builtin_bit_cast(unsigned, f); return (u + 0x7fffu + ((u >> 16) & 1u)) >> 16; }
__device__ __forceinline__ unsigned pk2(float lo, float hi) { return f2bf(lo) | (f2bf(hi) << 16); }

#define XB_TMO      128
#define XB_XCNT(j)  (256  + 64 * (j))
#define XB_XSUB(j)  (1280 + 64 * (j))
#define XB_XGEN(j)  (2304 + 64 * (j))
#define XB_TOP      3328
#define XB_TOPGEN   3392
#define XCD_BAR_WORDS 3456
#define XB_SPIN_CAP (1u << 18)

__device__ __forceinline__ unsigned xb_ld(unsigned* p)              { return __hip_atomic_load(p, __ATOMIC_RELAXED, __HIP_MEMORY_SCOPE_AGENT); }
__device__ __forceinline__ unsigned xb_add(unsigned* p, unsigned v) { return __hip_atomic_fetch_add(p, v, __ATOMIC_RELAXED, __HIP_MEMORY_SCOPE_AGENT); }
__device__ __forceinline__ unsigned xb_xcc_id() { return (unsigned)__builtin_amdgcn_s_getreg((3 << 11) | 20) & 0xFu; }
#define XB_SPIN(cond, bar) do { unsigned _sp = 0; while (cond) { __builtin_amdgcn_s_sleep(1); \
    if ((++_sp & 255u) == 0u) { if (xb_ld(&(bar)[XB_TMO])) break; if (_sp > XB_SPIN_CAP) { atomicAdd(&(bar)[XB_TMO], 1u); break; } } } } while (0)

struct XcdBarrier {
    unsigned* bar; unsigned x;
    volatile LAS unsigned* st;
};

__device__ __forceinline__ XcdBarrier xcd_barrier_post(unsigned* bar, volatile LAS unsigned* st) {
    XcdBarrier b; b.bar = bar; b.x = xb_xcc_id(); b.st = st;
    if (threadIdx.x == 0) (void)xb_add(&bar[XB_XCNT(b.x)], 1u);
    return b;
}
__device__ __forceinline__ void xcd_barrier_complete(unsigned* bar, unsigned x, unsigned& nloc, unsigned& nx) {
    const unsigned G = gridDim.x * gridDim.y * gridDim.z;
    unsigned sum, cnt, mine, sp = 0u;
    for (;;) {
        sum = 0u; cnt = 0u; mine = 0u;
#pragma unroll
        for (unsigned j = 0; j < 16; ++j) { const unsigned c = xb_ld(&bar[XB_XCNT(j)]); sum += c; cnt += (c > 0u) ? 1u : 0u; mine = (j == x) ? c : mine; }
        if (sum == G) break;
        __builtin_amdgcn_s_sleep(1);
        if ((++sp & 255u) == 0u) { if (xb_ld(&bar[XB_TMO])) break; if (sp > XB_SPIN_CAP) { atomicAdd(&bar[XB_TMO], 1u); break; } }
    }
    nloc = mine > 0u ? mine : 1u; nx = cnt > 0u ? cnt : 1u;
}

__device__ __forceinline__ void xcd_barrier(const XcdBarrier& b) {
    asm volatile("s_waitcnt vmcnt(0)" ::: "memory");
    __syncthreads();
    if (threadIdx.x == 0) {
        unsigned* bar = b.bar;
        __builtin_amdgcn_s_waitcnt(0);
        unsigned nloc = b.st[0], nx = b.st[1];
        if (nloc == 0u) { xcd_barrier_complete(bar, b.x, nloc, nx); b.st[0] = nloc; b.st[1] = nx; }
        const unsigned old = xb_add(&bar[XB_XSUB(b.x)], 1u);
        const unsigned gen = old / nloc;
        if (old + 1u == (gen + 1u) * nloc) {
            __builtin_amdgcn_fence(__ATOMIC_RELEASE, "agent");
            asm volatile("s_waitcnt vmcnt(0)" ::: "memory");
            const unsigned og = xb_add(&bar[XB_TOP], 1u);
            const unsigned tg = og / nx;
            if (og + 1u == (tg + 1u) * nx) xb_add(&bar[XB_TOPGEN], 1u);
            else XB_SPIN(xb_ld(&bar[XB_TOPGEN]) == tg, bar);
            __builtin_amdgcn_fence(__ATOMIC_ACQUIRE, "agent");
            xb_add(&bar[XB_XGEN(b.x)], 1u);
            asm volatile("s_waitcnt vmcnt(0)" ::: "memory");
        } else {
            XB_SPIN(xb_ld(&bar[XB_XGEN(b.x)]) == gen, bar);
            __builtin_amdgcn_fence(__ATOMIC_ACQUIRE, "agent");
            asm volatile("s_waitcnt vmcnt(0)" ::: "memory");
        }
    }
    __syncthreads();
}

constexpr int NWAVES = 8;
#ifndef MK_N_LAUNCHES
#define MK_N_LAUNCHES 5
#endif
constexpr int N_LAUNCHES = MK_N_LAUNCHES;
constexpr int PER_PHASE = 5;
constexpr int DM = 2048, BATCH = 8, SEQ = 2048, DBATCH = 16, DSEQ = 32;
constexpr int MP = BATCH * SEQ, MS = DBATCH * DSEQ, M = MP + MS;
constexpr int DIN = 4608, DATT = 1024, DKV = 256, DLRU = 1024, NKV = 4, HD = 64, NLB = 16;
constexpr int KVBUF = 128, SROWS = KVBUF + DSEQ;
constexpr float LN_EPS = 1e-5f;
constexpr float DN_ALPHA = 1.189207115002721f;
constexpr float LOG2E = 1.4426950408889634f;
constexpr float QSCALE = 0.125f * LOG2E;
constexpr size_t OFF_Y = 0, OFF_KWP = 34603008, OFF_VWP = OFF_KWP + 262144, OFF_CP = OFF_VWP + 262144, OFF_HP = OFF_CP + 24576,
                 OFF_KWS = OFF_HP + 8192, OFF_VWS = OFF_KWS + 524288, OFF_CS = OFF_VWS + 524288, OFF_HS = OFF_CS + 49152, OUT_TOTAL = OFF_HS + 16384;
constexpr size_t MiB = 1u << 20;
constexpr size_t WS_CTL = 0, CTL_ZERO_BYTES = 1 * MiB;
constexpr size_t WS_WIN = 2 * MiB, WS_WOUT = 20 * MiB, WS_WG = 28 * MiB, WS_XCH = 30 * MiB;
constexpr size_t WS_XN = 32 * MiB, WS_Q = 98 * MiB, WS_K = 131 * MiB, WS_V = 141 * MiB, WS_GA = 151 * MiB, WS_XL = 184 * MiB, WS_GL = 217 * MiB, WS_U = 250 * MiB, WS_END = 316 * MiB;
constexpr int CW_TMO = 0, CW_CODE = 1, CW_BAR = 4096;
constexpr int RING_OFF = 0, RING_BYTES = 131072, LDSCTL_OFF = RING_BYTES, MISC_OFF = LDSCTL_OFF + 320, LDS_BYTES = 147456;

struct Frame {
    LAS unsigned char* lds; volatile LAS unsigned* MISC; gu32* ctl;
    int tid, lane, wave, vcu, G;
};

__device__ __forceinline__ float bf2f(unsigned short h) { return __uint_as_float((unsigned)h << 16); }
__device__ __forceinline__ float bflo(unsigned w) { return __uint_as_float(w << 16); }
__device__ __forceinline__ float bfhi(unsigned w) { return __uint_as_float(w & 0xffff0000u); }

__device__ __forceinline__ void p0_transpose_item(const float* W, int K, int N, bf16* WT, LAS float* scr, int item, int lane) {
    const int nblk = N / 32, kb = item / nblk, nb = item % nblk, k0 = 64 * kb, n0 = 32 * nb;
#pragma unroll 8
    for (int i = 0; i < 32; ++i) { const int kk = 2 * i + (lane >> 5); scr[kk * 33 + (lane & 31)] = W[(size_t)(k0 + kk) * N + n0 + (lane & 31)]; }
    LDS_WAIT(); asm volatile("" ::: "memory");
    const int c = lane & 7;
#pragma unroll
    for (int j = 0; j < 4; ++j) { const int n = (lane >> 3) + 8 * j; const LAS float* s = scr + (8 * c) * 33 + n;
        v4u o; o.x = pk2(s[0 * 33], s[1 * 33]); o.y = pk2(s[2 * 33], s[3 * 33]); o.z = pk2(s[4 * 33], s[5 * 33]); o.w = pk2(s[6 * 33], s[7 * 33]);
        *(GAS v4u*)(WT + (size_t)(n0 + n) * K + k0 + 8 * c) = o; }
    LDS_WAIT(); asm volatile("" ::: "memory");
}
struct Args { const float* in[19]; float* out; unsigned char* ws; int ph_lo, ph_hi, li, pad; };

__device__ __forceinline__ void p0_prologue(Frame& F, const Args& a) {
    LAS float* scr = (LAS float*)(F.lds + RING_OFF + F.wave * 16384);
    const int gw = F.vcu * NWAVES + F.wave, NGW = F.G * NWAVES, lane = F.lane;
    unsigned char* ws = a.ws;
    bf16* WinT = (bf16*)(ws + WS_WIN); bf16* WoutT = (bf16*)(ws + WS_WOUT); bf16* WG = (bf16*)(ws + WS_WG);
    constexpr int I_IN = (DM / 64) * (DIN / 32), I_OUT = (DM / 64) * (DM / 32), I_G = 2 * NLB * 2;
    for (int it = gw; it < I_IN + I_OUT + I_G; it += NGW) {
        int r = it;
        if (r < I_IN) { p0_transpose_item(a.in[6], DM, DIN, WinT, scr, r, lane); continue; } r -= I_IN;
        if (r < I_OUT) { p0_transpose_item(a.in[16], DM, DM, WoutT, scr, r, lane); continue; } r -= I_OUT;
        const int gate = r / (NLB * 2), blk = (r / 2) % NLB, sub = r & 1;
        p0_transpose_item(a.in[gate ? 12 : 10] + blk * 4096, 64, 64, WG + gate * 65536 + blk * 4096, scr, sub, lane);
    }
    bf16* XN = (bf16*)(ws + WS_XN);
    for (int m = gw; m < M; m += NGW) {
        const float* xr = (m < MP) ? a.in[0] + (size_t)m * DM : a.in[1] + (size_t)(m - MP) * DM;
#pragma unroll
        for (int j = 0; j < 4; ++j) { const int idx = j * 512 + lane * 8;
            const f32x4 v0 = *(const GAS f32x4*)(xr + idx), v1 = *(const GAS f32x4*)(xr + idx + 4);
            v4u o; o.x = pk2(v0.x, v0.y); o.y = pk2(v0.z, v0.w); o.z = pk2(v1.x, v1.y); o.w = pk2(v1.z, v1.w);
            *(GAS v4u*)(XN + (size_t)m * DM + idx) = o; }
    }
    bf16* KB = (bf16*)(ws + WS_K); bf16* VB = (bf16*)(ws + WS_V);
    for (int i = gw; i < 2 * DBATCH * KVBUF; i += NGW) {
        const int kv = i / (DBATCH * KVBUF), rr = i % (DBATCH * KVBUF), b = rr / KVBUF, r = rr % KVBUF;
        const float* src = a.in[kv ? 3 : 2] + (size_t)rr * DKV;
        const f32x4 v = *(const GAS f32x4*)(src + lane * 4);
        bf16* dst = (kv ? VB : KB) + (size_t)(MP + b * SROWS + r) * DKV + lane * 4;
        *(GAS unsigned long long*)dst = (unsigned long long)pk2(v.x, v.y) | ((unsigned long long)pk2(v.z, v.w) << 32);
        if (r >= DSEQ) *(GAS f32x4*)(a.out + (kv ? OFF_VWS : OFF_KWS) + (size_t)(b * KVBUF + r - DSEQ) * DKV + lane * 4) = v;
    }
    for (int i = gw; i < 2 * 64; i += NGW) { const int kv = i / 64, r = i % 64;
        bf16* dst = (kv ? VB : KB) + (size_t)(MP + DBATCH * SROWS + r) * DKV + lane * 4; *(GAS unsigned long long*)dst = 0ull; }
}

typedef float f32x16 __attribute__((ext_vector_type(16)));
typedef short s16x4 __attribute__((ext_vector_type(4)));
typedef short v4i16_t __attribute__((ext_vector_type(4)));
typedef LAS const char* lds_cptr;
__device__ __forceinline__ int crow(int r, int hi) { return (r & 3) + 8 * (r >> 2) + 4 * hi; }
__device__ __forceinline__ s16x4 vtr(lds_cptr p) { return __builtin_bit_cast(s16x4, __builtin_amdgcn_ds_read_tr16_b64_v4i16((LAS v4i16_t*)p)); }
__device__ __forceinline__ unsigned cvtpk(float lo, float hi) { unsigned r; asm volatile("v_cvt_pk_bf16_f32 %0, %1, %2" : "=v"(r) : "v"(lo), "v"(hi)); return r; }
__device__ __forceinline__ float swap_max(float m) { auto rr = __builtin_amdgcn_permlane32_swap(__float_as_uint(m), __float_as_uint(m), false, false); return fmaxf(__uint_as_float(rr[0]), __uint_as_float(rr[1])); }
__device__ __forceinline__ float swap_sum(float m) { auto rr = __builtin_amdgcn_permlane32_swap(__float_as_uint(m), __float_as_uint(m), false, false); return __uint_as_float(rr[0]) + __uint_as_float(rr[1]); }

constexpr int AT_K = 0, AT_V = 3 * 8192, AT_WS = 6 * 8192;

template <bool SAMPLE>
__device__ __forceinline__ void attn_unit(Frame& F, const Args& a, int b, int c, int kvh) {
    const int lane = F.lane, wid = F.wave, r32 = lane & 31, hi = lane >> 5;
    unsigned char* ws = a.ws;
    const bf16* Q = (const bf16*)(ws + WS_Q); const bf16* KB = (const bf16*)(ws + WS_K); const bf16* VB = (const bf16*)(ws + WS_V);
    const bf16* GA = (const bf16*)(ws + WS_GA); bf16* U = (bf16*)(ws + WS_U);
    const int qrow0 = SAMPLE ? MP + b * DSEQ : b * SEQ + 64 * c;
    const int krow0 = SAMPLE ? MP + b * SROWS : b * SEQ + 64 * (c - 2);
    const int jlo = SAMPLE ? 0 : (c >= 2 ? 0 : 2 - c);
    const int qposb = SAMPLE ? 2048 : 64 * c, kposb = SAMPLE ? 1920 : 64 * (c - 2);
    LAS unsigned char* L = F.lds + RING_OFF;
#pragma unroll
    for (int j = 0; j < 3; ++j) {
        if (j >= jlo) {
            const v4u kv = *(const GAS v4u*)(KB + (size_t)(krow0 + 64 * j + lane) * DKV + kvh * HD + wid * 8);
            const v4u vv = *(const GAS v4u*)(VB + (size_t)(krow0 + 64 * j + 16 * (wid & 3) + (lane >> 2)) * DKV + kvh * HD + (wid >> 2) * 32 + (lane & 3) * 8);
            *(LAS v4u*)(L + AT_K + j * 8192 + wid * 1024 + lane * 16) = kv;
            *(LAS v4u*)(L + AT_V + j * 8192 + wid * 1024 + lane * 16) = vv;
        }
    }
    __syncthreads();
    const bool active = !(SAMPLE && (wid & 1));
    if (active) {
        const int g = wid >> 1, head = 4 * kvh + g, qr0 = qrow0 + 32 * (wid & 1);
        bf16x8 qr[4];
#pragma unroll
        for (int d0 = 0; d0 < 4; ++d0) qr[d0] = *(const GAS bf16x8*)(Q + (size_t)(qr0 + r32) * DATT + head * HD + d0 * 16 + hi * 8);
        f32x16 p[3][2];
#pragma unroll
        for (int j = 0; j < 3; ++j) {
            p[j][0] = f32x16{}; p[j][1] = f32x16{};
            if (j >= jlo) {
                const LAS unsigned char* kb = L + AT_K + j * 8192 + hi * 1024 + r32 * 16;
#pragma unroll
                for (int d0 = 0; d0 < 4; ++d0) {
                    const bf16x8 b0 = *(const LAS bf16x8*)(kb + d0 * 2048), b1 = *(const LAS bf16x8*)(kb + d0 * 2048 + 512);
                    p[j][0] = __builtin_amdgcn_mfma_f32_32x32x16_bf16(b0, qr[d0], p[j][0], 0, 0, 0);
                    p[j][1] = __builtin_amdgcn_mfma_f32_32x32x16_bf16(b1, qr[d0], p[j][1], 0, 0, 0);
                }
            }
        }
        const float slope2 = exp2f(-0.5f * (float)(head + 1)) * LOG2E;
        const float sink2 = a.in[15][head] * LOG2E;
        const int qpos = qposb + 32 * (wid & 1) + r32;
        float mx = sink2;
#pragma unroll
        for (int j = 0; j < 3; ++j)
#pragma unroll
            for (int h2 = 0; h2 < 2; ++h2)
#pragma unroll
                for (int r = 0; r < 16; ++r) {
                    const int kvi = crow(r, hi) + 32 * h2, kpos = kposb + 64 * j + kvi;
                    const float dist = fabsf((float)(qpos - kpos));
                    float s = p[j][h2][r] - slope2 * dist;
                    const bool valid = (j >= jlo) && !(SAMPLE && j == 2 && h2 == 1);
                    s = valid ? s : -1e30f;
                    p[j][h2][r] = s; mx = fmaxf(mx, s);
                }
        mx = swap_max(mx);
        float l = 0.f;
#pragma unroll
        for (int j = 0; j < 3; ++j)
#pragma unroll
            for (int h2 = 0; h2 < 2; ++h2)
#pragma unroll
                for (int r = 0; r < 16; ++r) { const float e = __builtin_amdgcn_exp2f(p[j][h2][r] - mx); p[j][h2][r] = e; l += e; }
        l = swap_sum(l) + __builtin_amdgcn_exp2f(sink2 - mx);
        LAS float* wsf = (LAS float*)(L + AT_WS) + wid * 64;
        if (hi == 0) wsf[r32] = __builtin_amdgcn_rcpf(l);
        f32x16 o[2]; o[0] = f32x16{}; o[1] = f32x16{};
#pragma unroll
        for (int j = 0; j < 3; ++j) {
            if (j >= jlo) {
                v4u pw[4];
#pragma unroll
                for (int k = 0; k < 4; ++k) {
                    const f32x16& P = p[j][k >> 1]; const int o8 = (k & 1) * 8;
                    pw[k] = (v4u){cvtpk(P[o8 + 0], P[o8 + 1]), cvtpk(P[o8 + 2], P[o8 + 3]), cvtpk(P[o8 + 4], P[o8 + 5]), cvtpk(P[o8 + 6], P[o8 + 7])};
                }
                const lds_cptr vp = (lds_cptr)(L + AT_V + j * 8192) + ((lane >> 4) & 1) * 32 + (lane & 3) * 8 + (4 * hi + ((lane & 15) >> 2)) * 64;
#pragma unroll
                for (int d0 = 0; d0 < 2; ++d0)
#pragma unroll
                    for (int ks = 0; ks < 4; ++ks) {
                        const s16x4 lo = vtr(vp + d0 * 4096 + ks * 1024), hh = vtr(vp + d0 * 4096 + ks * 1024 + 512);
                        const bf16x8 vf = (bf16x8){lo[0], lo[1], lo[2], lo[3], hh[0], hh[1], hh[2], hh[3]};
                        o[d0] = __builtin_amdgcn_mfma_f32_32x32x16_bf16(__builtin_bit_cast(bf16x8, pw[ks]), vf, o[d0], 0, 0, 0);
                    }
            }
        }
        LDS_WAIT();
#pragma unroll
        for (int r = 0; r < 16; ++r) {
            const int q = crow(r, hi); const float rl = wsf[q];
            const size_t row = (size_t)(qr0 + q);
#pragma unroll
            for (int d0 = 0; d0 < 2; ++d0) {
                const int col = head * HD + d0 * 32 + r32;
                const float gv = bf2f(GA[row * DATT + col]);
                U[row * DM + col] = (bf16)f2bf(o[d0][r] * rl * gv);
            }
        }
    }
    __syncthreads();
}

constexpr int LR_XCF = 0, LR_XCB = 16640, LR_AS = 25856, LR_BS = 42496, LR_SEGA = 59136, LR_SEGB = 61184, LR_HC = 63232;
template <bool SAMPLE>
__device__ __forceinline__ void lru_unit(Frame& F, const Args& a, int b, int n) {
    const int tid = F.tid, lane = F.lane, wid = F.wave;
    unsigned char* ws = a.ws;
    const bf16* XL = (const bf16*)(ws + WS_XL); const bf16* GL = (const bf16*)(ws + WS_GL); const bf16* WG = (const bf16*)(ws + WS_WG); bf16* U = (bf16*)(ws + WS_U);
    constexpr int T = SAMPLE ? DSEQ : SEQ, NT = SAMPLE ? 1 : SEQ / 64;
    const int row0 = SAMPLE ? MP + b * DSEQ : b * SEQ;
    LAS unsigned char* L = F.lds + RING_OFF;
    LAS float* XCF = (LAS float*)(L + LR_XCF); LAS float* AS = (LAS float*)(L + LR_AS); LAS float* BS = (LAS float*)(L + LR_BS);
    LAS float* SEGA = (LAS float*)(L + LR_SEGA); LAS float* SEGB = (LAS float*)(L + LR_SEGB); LAS float* HC = (LAS float*)(L + LR_HC);
    const int m = wid & 3, chh = wid >> 2, fr = lane & 15, fq = lane >> 4;
    bf16x8 bfr[2][2][2]; float bga[2], bgx[2], spl[2];
#pragma unroll
    for (int gate = 0; gate < 2; ++gate)
#pragma unroll
        for (int nb = 0; nb < 2; ++nb)
#pragma unroll
            for (int ks = 0; ks < 2; ++ks) bfr[gate][nb][ks] = *(const GAS bf16x8*)(WG + gate * 65536 + n * 4096 + (32 * chh + 16 * nb + fr) * 64 + 32 * ks + 8 * fq);
#pragma unroll
    for (int nb = 0; nb < 2; ++nb) { const int ch = 64 * n + 32 * chh + 16 * nb + fr; bga[nb] = a.in[11][ch]; bgx[nb] = a.in[13][ch]; spl[nb] = -8.0f * log1pf(expf(-a.in[14][ch])); }
    const int t_c = tid >> 3, cg = tid & 7, chc = 64 * n + 8 * cg;
    float cw[4][8], cb[8];
#pragma unroll
    for (int j = 0; j < 4; ++j) { const f32x4 w0 = *(const GAS f32x4*)(a.in[8] + j * DLRU + chc), w1 = *(const GAS f32x4*)(a.in[8] + j * DLRU + chc + 4);
        cw[j][0] = w0.x; cw[j][1] = w0.y; cw[j][2] = w0.z; cw[j][3] = w0.w; cw[j][4] = w1.x; cw[j][5] = w1.y; cw[j][6] = w1.z; cw[j][7] = w1.w; }
    { const f32x4 w0 = *(const GAS f32x4*)(a.in[9] + chc), w1 = *(const GAS f32x4*)(a.in[9] + chc + 4);
        cb[0] = w0.x; cb[1] = w0.y; cb[2] = w0.z; cb[3] = w0.w; cb[4] = w1.x; cb[5] = w1.y; cb[6] = w1.z; cb[7] = w1.w; }
    const int ch_s = tid & 63, seg = wid;
    if (tid < 64) HC[tid] = SAMPLE ? a.in[5][b * DLRU + 64 * n + tid] : 0.f;
    for (int tile = 0; tile < NT; ++tile) {
        {
            const int t = tile * 64 + t_c;
            float xc[8];
#pragma unroll
            for (int i = 0; i < 8; ++i) xc[i] = cb[i];
#pragma unroll
            for (int j = 0; j < 4; ++j) {
                const int tt = t - 3 + j; float xv[8];
                if (tt >= 0) {
                    const v4u w = (tt < T) ? *(const GAS v4u*)(XL + (size_t)(row0 + tt) * DLRU + chc) : (v4u){0u, 0u, 0u, 0u};
                    xv[0] = bflo(w.x); xv[1] = bfhi(w.x); xv[2] = bflo(w.y); xv[3] = bfhi(w.y); xv[4] = bflo(w.z); xv[5] = bfhi(w.z); xv[6] = bflo(w.w); xv[7] = bfhi(w.w);
                } else if (SAMPLE) {
                    const float* sp = a.in[4] + (size_t)(b * 3 + 3 + tt) * DLRU + chc;
                    const f32x4 w0 = *(const GAS f32x4*)sp, w1 = *(const GAS f32x4*)(sp + 4);
                    xv[0] = w0.x; xv[1] = w0.y; xv[2] = w0.z; xv[3] = w0.w; xv[4] = w1.x; xv[5] = w1.y; xv[6] = w1.z; xv[7] = w1.w;
                } else {
#pragma unroll
                    for (int i = 0; i < 8; ++i) xv[i] = 0.f;
                }
#pragma unroll
                for (int i = 0; i < 8; ++i) xc[i] += cw[j][i] * xv[i];
            }
#pragma unroll
            for (int i = 0; i < 8; ++i) XCF[t_c * 65 + 8 * cg + i] = xc[i];
            v4u pk; pk.x = pk2(xc[0], xc[1]); pk.y = pk2(xc[2], xc[3]); pk.z = pk2(xc[4], xc[5]); pk.w = pk2(xc[6], xc[7]);
            *(LAS v4u*)(L + LR_XCB + t_c * 144 + cg * 16) = pk;
        }
        __syncthreads();
        {
            f32x4 acc[2][2];
#pragma unroll
            for (int gate = 0; gate < 2; ++gate)
#pragma unroll
                for (int nb = 0; nb < 2; ++nb) acc[gate][nb] = (f32x4){0.f, 0.f, 0.f, 0.f};
#pragma unroll
            for (int ks = 0; ks < 2; ++ks) {
                const bf16x8 af = *(const LAS bf16x8*)(L + LR_XCB + (16 * m + fr) * 144 + (32 * ks + 8 * fq) * 2);
#pragma unroll
                for (int gate = 0; gate < 2; ++gate)
#pragma unroll
                    for (int nb = 0; nb < 2; ++nb) acc[gate][nb] = __builtin_amdgcn_mfma_f32_16x16x32_bf16(af, bfr[gate][nb][ks], acc[gate][nb], 0, 0, 0);
            }
#pragma unroll
            for (int nb = 0; nb < 2; ++nb)
#pragma unroll
                for (int r = 0; r < 4; ++r) {
                    const int tl = 16 * m + 4 * fq + r, ch = 32 * chh + 16 * nb + fr;
                    const float rg = __builtin_amdgcn_rcpf(1.0f + __expf(-(acc[0][nb][r] + bga[nb])));
                    const float ig = __builtin_amdgcn_rcpf(1.0f + __expf(-(acc[1][nb][r] + bgx[nb])));
                    const float la = spl[nb] * rg, av = __expf(la);
                    const float mult = sqrtf(fmaxf(1.0f - __expf(2.0f * la), 0.f));
                    AS[tl * 65 + ch] = av; BS[tl * 65 + ch] = mult * ig * XCF[tl * 65 + ch];
                }
        }
        __syncthreads();
        {
            float A = 1.f, B = 0.f;
#pragma unroll
            for (int i = 0; i < 8; ++i) { const float av = AS[(8 * seg + i) * 65 + ch_s], bv = BS[(8 * seg + i) * 65 + ch_s]; A *= av; B = av * B + bv; }
            SEGA[seg * 64 + ch_s] = A; SEGB[seg * 64 + ch_s] = B;
        }
        __syncthreads();
        {
            float h = HC[(tile & 1) * 64 + ch_s];
            for (int s = 0; s < seg; ++s) h = SEGA[s * 64 + ch_s] * h + SEGB[s * 64 + ch_s];
#pragma unroll
            for (int i = 0; i < 8; ++i) {
                const int tl = 8 * seg + i, t = tile * 64 + tl;
                h = AS[tl * 65 + ch_s] * h + BS[tl * 65 + ch_s];
                if (t < T) {
                    const size_t row = (size_t)(row0 + t);
                    const float gv = bf2f(GL[row * DLRU + 64 * n + ch_s]);
                    U[row * DM + DATT + 64 * n + ch_s] = (bf16)f2bf(h * gv);
                    if (t == T - 1) a.out[(SAMPLE ? OFF_HS : OFF_HP) + (size_t)b * DLRU + 64 * n + ch_s] = h;
                }
            }
            if (seg == 7) HC[((tile + 1) & 1) * 64 + ch_s] = h;
        }
        __syncthreads();
    }
}

__device__ __forceinline__ float wave_sum(float v) {
#pragma unroll
    for (int o = 1; o < 64; o <<= 1) v += __shfl_xor(v, o);
    return v;
}
__device__ __forceinline__ void ln_rows(Frame& F, const Args& a) {
    const int gw = F.vcu * NWAVES + F.wave, NGW = F.G * NWAVES, lane = F.lane;
    f32x4 gg[8], bb[8];
#pragma unroll
    for (int j = 0; j < 8; ++j) { gg[j] = *(const GAS f32x4*)(a.in[17] + j * 256 + lane * 4); bb[j] = *(const GAS f32x4*)(a.in[18] + j * 256 + lane * 4); }
    for (int m = gw; m < M; m += NGW) {
        float* p = a.out + (size_t)m * DM;
        f32x4 v[8]; float s = 0.f;
#pragma unroll
        for (int j = 0; j < 8; ++j) { v[j] = *(const GAS f32x4*)(p + j * 256 + lane * 4); s += (v[j].x + v[j].y) + (v[j].z + v[j].w); }
        const float mean = wave_sum(s) * (1.f / DM); float s2 = 0.f;
#pragma unroll
        for (int j = 0; j < 8; ++j) { v[j] = v[j] - mean; s2 += (v[j].x * v[j].x + v[j].y * v[j].y) + (v[j].z * v[j].z + v[j].w * v[j].w); }
        const float rstd = 1.f / sqrtf(wave_sum(s2) * (1.f / DM) + LN_EPS);
#pragma unroll
        for (int j = 0; j < 8; ++j) *(GAS f32x4*)(p + j * 256 + lane * 4) = v[j] * rstd * gg[j] + bb[j];
    }
}

__global__ void __launch_bounds__(NWAVES * 64, 2) hymba_fwd(Args args) {
    extern __shared__ __attribute__((aligned(16))) unsigned char lds[];
    Frame F;
    F.lds = (LAS unsigned char*)lds;
    F.MISC = (volatile LAS unsigned*)(F.lds + MISC_OFF);
    F.tid = threadIdx.x; F.lane = F.tid & 63; F.wave = __builtin_amdgcn_readfirstlane(F.tid >> 6);
    F.G = gridDim.x; { const int bx = blockIdx.x; F.vcu = (F.G % 8 == 0) ? (bx % 8) * (F.G / 8) + bx / 8 : bx; }
    unsigned char* ws = args.ws;
    F.ctl = (gu32*)(ws + WS_CTL);
    for (int u = F.tid; u < (LDS_BYTES - LDSCTL_OFF) / 4; u += NWAVES * 64) ((LAS unsigned*)(F.lds + LDSCTL_OFF))[u] = 0u;
    __syncthreads();
    XcdBarrier bar; bar.bar = (unsigned*)(F.ctl + CW_BAR); bar.x = 0; bar.st = nullptr;
    if (N_LAUNCHES != PER_PHASE) bar = xcd_barrier_post((unsigned*)(F.ctl + CW_BAR), F.MISC + 8);
#define GRID_BAR() do { if (N_LAUNCHES != PER_PHASE) xcd_barrier(bar); } while (0)
    const int lo = args.ph_lo, hi = args.ph_hi;
#define IN(k) (lo <= (k) && (k) < hi)
#define BOTH(k) (IN(k) && IN((k) + 1))

    if (IN(0)) { p0_prologue(F, args); if (BOTH(0)) GRID_BAR(); }

    if (IN(1)) {
        pg8::Gemm g{(const pg8::bf16_t*)(ws + WS_XN), (const pg8::bf16_t*)(ws + WS_WIN), M, DIN, DM}; pg8::StaticOrder S; S.init(M, DIN, F.G, (int)blockIdx.x);
        pg8::EpiZ E{(pg8::bf16_t*)(ws + WS_Q), (pg8::bf16_t*)(ws + WS_K), (pg8::bf16_t*)(ws + WS_V), (pg8::bf16_t*)(ws + WS_GA), (pg8::bf16_t*)(ws + WS_XL), (pg8::bf16_t*)(ws + WS_GL), args.in[7], args.out, QSCALE};
        pg8::gemm_phase<pg8::EpiZ, pg8::StaticOrder, true, true>(F.lds + RING_OFF, g, S, E);
        if (BOTH(1)) GRID_BAR();
    }

    if (IN(2)) {
        const int v = F.vcu, G = F.G;
        const int nlp = BATCH * NLB, nls = DBATCH * NLB, nap = BATCH * 32 * NKV, nas = DBATCH * NKV;
        if (v < nlp && G > nlp) lru_unit<false>(F, args, v / NLB, v % NLB);
        const int first = (G > nlp) ? nlp : 0, nw = (G > nlp) ? G - nlp : G;
        if (G <= nlp) for (int i = v; i < nlp; i += G) lru_unit<false>(F, args, i / NLB, i % NLB);
        if (G <= nlp || v >= first) {
            const int vv = (G > nlp) ? v - first : v;
            for (int i = vv; i < nls; i += nw) lru_unit<true>(F, args, i / NLB, i % NLB);
            for (int i = vv; i < nap; i += nw) { const int kvh = i % NKV, c = (i / NKV) % 32, b = i / (NKV * 32); attn_unit<false>(F, args, b, c, kvh); }
            for (int i = vv; i < nas; i += nw) attn_unit<true>(F, args, i / NKV, 0, i % NKV);
        }
        if (BOTH(2)) GRID_BAR();
    }

    if (IN(3)) {
        pg8::Gemm g{(const pg8::bf16_t*)(ws + WS_U), (const pg8::bf16_t*)(ws + WS_WOUT), M, DM, DM}; pg8::StaticOrder S; S.init(M, DM, F.G, (int)blockIdx.x);
        pg8::EpiPre E{args.in[0], args.in[1], args.out, DN_ALPHA};
        pg8::gemm_phase<pg8::EpiPre, pg8::StaticOrder, true, true>(F.lds + RING_OFF, g, S, E);
        if (BOTH(3)) GRID_BAR();
    }

    if (IN(4)) ln_rows(F, args);
#undef IN
#undef BOTH
}

extern "C" void kernel_launch(void* const* d_in, const int* in_sizes, int n_in, void* d_out, int out_size, void* d_ws, size_t ws_size, hipStream_t stream) {
    static int grid = 0;
    if (grid == 0) {
        if (n_in != 19 || in_sizes[0] != MP * DM || (size_t)out_size != OUT_TOTAL || ws_size < WS_END) { fprintf(stderr, "kernel_launch: unexpected shapes (n_in %d, in0 %d, out %d, ws %zu)\n", n_in, n_in > 0 ? in_sizes[0] : -1, out_size, ws_size); grid = -1; return; }
        int dev = 0, cus = 0, per_cu = 0;
        if (hipGetDevice(&dev) != hipSuccess || hipDeviceGetAttribute(&cus, hipDeviceAttributeMultiprocessorCount, dev) != hipSuccess) { grid = -1; return; }
        if (hipFuncSetAttribute((const void*)hymba_fwd, hipFuncAttributeMaxDynamicSharedMemorySize, LDS_BYTES) != hipSuccess) { fprintf(stderr, "kernel_launch: hipFuncSetAttribute failed\n"); grid = -1; return; }
        if (hipOccupancyMaxActiveBlocksPerMultiprocessor(&per_cu, (const void*)hymba_fwd, NWAVES * 64, LDS_BYTES) != hipSuccess || per_cu < 1) { fprintf(stderr, "kernel_launch: occupancy query says %d blocks per CU\n", per_cu); (void)hipGetLastError(); grid = -1; return; }
        grid = cus;
    }
    if (grid < 0) return;
    if (hipMemsetAsync((char*)d_ws + WS_CTL, 0, CTL_ZERO_BYTES, stream) != hipSuccess) return;
    Args a{};
    for (int i = 0; i < 19; ++i) a.in[i] = (const float*)d_in[i];
    a.out = (float*)d_out; a.ws = (unsigned char*)d_ws;
    for (int li = 0; li < N_LAUNCHES; ++li) {
        a.ph_lo = (N_LAUNCHES == PER_PHASE) ? li : 0; a.ph_hi = (N_LAUNCHES == PER_PHASE) ? li + 1 : PER_PHASE; a.li = li;
        hipLaunchKernelGGL(hymba_fwd, dim3(grid), dim3(NWAVES * 64), LDS_BYTES, stream, a);
    }
}
```
